# Optimizing an MI355X kernel written in HIP

```python
import math
import jax, jax.numpy as jnp
from jax import lax
import numpy as np

D_MODEL = 1024
BATCH = 8
SEQ = 4096
DEPTH = 1

HEAD_DIM = 64
HEADS_PER_GROUP = 4
DILATION_PATTERNS = ((128, 1), (512, 4), (2048, 16))
N_ATTN_GROUPS = len(DILATION_PATTERNS)
N_ATTN_HEADS = N_ATTN_GROUPS * HEADS_PER_GROUP
ATTN_WIDTH = N_ATTN_HEADS * HEAD_DIM
ATTN_OUT_WIDTH = HEADS_PER_GROUP * HEAD_DIM
N_BUCKETS = 32
MAX_DISTANCE = 2048
SSM_WIDTH = D_MODEL // 2
SSM_GROUP = 16
SSM_GROUPS = SSM_WIDTH // SSM_GROUP
SSM_STATE = 64
DT_MIN = 1e-3
DT_MAX = 1e-1
D_FF = 4 * D_MODEL
ALPHA = (2.0 * DEPTH) ** 0.25
BETA = (8.0 * DEPTH) ** -0.25
LN_EPS = 1e-5
NEG_INF = -1e30
IN_WIDTH = 3 * ATTN_WIDTH + SSM_WIDTH + 2 * D_MODEL
SPLITS = (ATTN_WIDTH, 2 * ATTN_WIDTH, 3 * ATTN_WIDTH, 3 * ATTN_WIDTH + SSM_WIDTH)

kernel_name = "hybrid_s5_dilated_attn_gated_deepnorm"


def layer_norm(x, g, b):
    xf = x.astype(jnp.float32)
    mu = xf.mean(-1, keepdims=True)
    xc = xf - mu
    var = (xc * xc).mean(-1, keepdims=True)
    return (xc * lax.rsqrt(var + LN_EPS)).astype(x.dtype) * g + b


def t5_bucket(dist):
    max_exact = N_BUCKETS // 2
    d = jnp.maximum(dist, 1).astype(jnp.float32)
    large = max_exact + (jnp.log(d / max_exact) / math.log(MAX_DISTANCE / max_exact)
                         * (N_BUCKETS - max_exact)).astype(jnp.int32)
    large = jnp.minimum(large, N_BUCKETS - 1)
    return jnp.where(dist < max_exact, dist, large)


def dilated_window_attention(q, k, v, rel_bias, window, dilation):
    bsz, seqlen, nh, hd = q.shape
    span = window // dilation
    n = seqlen // dilation
    blk = min(span, n)
    nb = -(-n // blk)
    pad = nb * blk - n

    def to_blocks(t):
        t = t.reshape(bsz, n, dilation, nh, hd).transpose(0, 2, 3, 1, 4)
        t = jnp.pad(t, ((0, 0), (0, 0), (0, 0), (0, pad), (0, 0)))
        return t.reshape(bsz, dilation, nh, nb, blk, hd)

    def with_prev(t):
        prev = jnp.pad(t[:, :, :, :-1], ((0, 0), (0, 0), (0, 0), (1, 0), (0, 0), (0, 0)))
        return jnp.concatenate([prev, t], axis=4)

    qb, kb, vb = to_blocks(q), to_blocks(k), to_blocks(v)
    kw, vw = with_prev(kb), with_prev(vb)

    qi = jnp.arange(blk)[:, None]
    kj = jnp.arange(2 * blk)[None, :]
    rel = qi + blk - kj
    key_pos = jnp.arange(nb)[:, None, None] * blk - blk + kj[None]
    valid = (rel >= 0) & (rel <= span) & (key_pos >= 0)
    bias = rel_bias[t5_bucket(jnp.maximum(rel, 0) * dilation)]
    bias = bias.transpose(2, 0, 1)[:, None].astype(jnp.float32)

    logits = jnp.einsum('brhnqe,brhnke->brhnqk', qb, kw).astype(jnp.float32) * (hd ** -0.5) + bias
    logits = jnp.where(valid, logits, NEG_INF)
    m = logits.max(-1, keepdims=True)
    e = jnp.exp(logits - m)
    s = e.sum(-1, keepdims=True)
    out = jnp.einsum('brhnqk,brhnke->brhnqe', (e / s).astype(v.dtype), vw)
    lse = (m + jnp.log(s))[..., 0]

    out = out.reshape(bsz, dilation, nh, nb * blk, hd)[:, :, :, :n]
    out = out.transpose(0, 3, 1, 2, 4).reshape(bsz, seqlen, nh, hd)
    lse = lse.reshape(bsz, dilation, nh, nb * blk)[..., :n]
    lse = lse.transpose(0, 3, 1, 2).reshape(bsz, seqlen, nh)
    return out, lse


def s5_ssm(u, lambda_re, lambda_im, log_dt, b_re, b_im, c_re, c_im, d_skip):
    f32 = jnp.float32
    bsz, seqlen, _ = u.shape
    ug = u.reshape(bsz, seqlen, SSM_GROUPS, SSM_GROUP).astype(f32)
    dt = jnp.exp(log_dt.astype(f32))[:, None]
    lr, li = lambda_re.astype(f32), lambda_im.astype(f32)
    mag = jnp.exp(lr * dt)
    ab_re, ab_im = mag * jnp.cos(li * dt), mag * jnp.sin(li * dt)
    den = lr * lr + li * li
    nr = ab_re - 1.0
    k_re = (nr * lr + ab_im * li) / den
    k_im = (ab_im * lr - nr * li) / den
    bu_re = jnp.einsum('blgh,gph->blgp', ug, b_re.astype(f32))
    bu_im = jnp.einsum('blgh,gph->blgp', ug, b_im.astype(f32))
    x_re = k_re * bu_re - k_im * bu_im
    x_im = k_re * bu_im + k_im * bu_re
    a_re = jnp.broadcast_to(ab_re, x_re.shape)
    a_im = jnp.broadcast_to(ab_im, x_im.shape)

    def combine(left, right):
        a1r, a1i, b1r, b1i = left
        a2r, a2i, b2r, b2i = right
        return (a1r * a2r - a1i * a2i,
                a1r * a2i + a1i * a2r,
                a2r * b1r - a2i * b1i + b2r,
                a2r * b1i + a2i * b1r + b2i)

    _, _, h_re, h_im = lax.associative_scan(combine, (a_re, a_im, x_re, x_im), axis=1)
    y = (jnp.einsum('blgp,ghp->blgh', h_re, c_re.astype(f32))
         - jnp.einsum('blgp,ghp->blgh', h_im, c_im.astype(f32))
         + d_skip.astype(f32) * ug)
    return y.reshape(bsz, seqlen, SSM_WIDTH).astype(u.dtype)


def setup_inputs(seed: int = 0) -> dict:
    key = jax.random.key(seed)
    ks = jax.random.split(key, 24)
    nrm = jax.random.normal
    sd = D_MODEL ** -0.5
    x = nrm(ks[0], (BATCH, SEQ, D_MODEL), jnp.float32)
    w_in = jnp.concatenate([
        nrm(ks[1], (DEPTH, D_MODEL, 2 * ATTN_WIDTH)) * sd,
        nrm(ks[2], (DEPTH, D_MODEL, ATTN_WIDTH)) * (BETA * sd),
        nrm(ks[3], (DEPTH, D_MODEL, SSM_WIDTH)) * sd,
        nrm(ks[4], (DEPTH, D_MODEL, 2 * D_MODEL)) * sd,
    ], axis=-1)
    b_gate = 0.02 * nrm(ks[5], (DEPTH, 2 * D_MODEL))
    lambda_re = -0.5 + 0.01 * nrm(ks[6], (DEPTH, SSM_GROUPS, SSM_STATE))
    lambda_im = jnp.broadcast_to(math.pi * jnp.arange(SSM_STATE, dtype=jnp.float32),
                                 (DEPTH, SSM_GROUPS, SSM_STATE)) + 0.0
    log_dt = jax.random.uniform(ks[7], (DEPTH, SSM_GROUPS), jnp.float32,
                                math.log(DT_MIN), math.log(DT_MAX))
    bs = (2.0 * SSM_GROUP) ** -0.5
    ssm_b_re = nrm(ks[8], (DEPTH, SSM_GROUPS, SSM_STATE, SSM_GROUP)) * bs
    ssm_b_im = nrm(ks[9], (DEPTH, SSM_GROUPS, SSM_STATE, SSM_GROUP)) * bs
    ssm_c_re = nrm(ks[10], (DEPTH, SSM_GROUPS, SSM_GROUP, SSM_STATE)) * 0.5
    ssm_c_im = nrm(ks[11], (DEPTH, SSM_GROUPS, SSM_GROUP, SSM_STATE)) * 0.5
    ssm_d = nrm(ks[12], (DEPTH, SSM_GROUPS, SSM_GROUP))
    w_glu = nrm(ks[13], (DEPTH, SSM_WIDTH, 2 * SSM_WIDTH)) * SSM_WIDTH ** -0.5
    w_ssm_proj = nrm(ks[14], (DEPTH, SSM_WIDTH, D_MODEL)) * SSM_WIDTH ** -0.5
    rel_bias = 0.1 * nrm(ks[15], (N_BUCKETS, N_ATTN_HEADS))
    w_attn_proj = nrm(ks[16], (DEPTH, ATTN_OUT_WIDTH, D_MODEL)) * ATTN_OUT_WIDTH ** -0.5
    w_out = nrm(ks[17], (DEPTH, D_MODEL, D_MODEL)) * (BETA * sd)
    ln1_g = 1.0 + 0.02 * nrm(ks[18], (DEPTH, D_MODEL))
    ln1_b = 0.02 * nrm(ks[19], (DEPTH, D_MODEL))
    w_up = nrm(ks[20], (DEPTH, D_MODEL, D_FF)) * (BETA * sd)
    w_down = nrm(ks[21], (DEPTH, D_FF, D_MODEL)) * (BETA * D_FF ** -0.5)
    ln2_g = 1.0 + 0.02 * nrm(ks[22], (DEPTH, D_MODEL))
    ln2_b = 0.02 * nrm(ks[23], (DEPTH, D_MODEL))
    return {"x": x, "w_in": w_in, "b_gate": b_gate, "lambda_re": lambda_re,
            "lambda_im": lambda_im, "log_dt": log_dt, "ssm_b_re": ssm_b_re,
            "ssm_b_im": ssm_b_im, "ssm_c_re": ssm_c_re, "ssm_c_im": ssm_c_im,
            "ssm_d": ssm_d, "w_glu": w_glu, "w_ssm_proj": w_ssm_proj,
            "rel_bias": rel_bias, "w_attn_proj": w_attn_proj, "w_out": w_out,
            "ln1_g": ln1_g, "ln1_b": ln1_b, "w_up": w_up, "w_down": w_down,
            "ln2_g": ln2_g, "ln2_b": ln2_b}


def reference(x, w_in, b_gate, lambda_re, lambda_im, log_dt, ssm_b_re, ssm_b_im,
              ssm_c_re, ssm_c_im, ssm_d, w_glu, w_ssm_proj, rel_bias, w_attn_proj,
              w_out, ln1_g, ln1_b, w_up, w_down, ln2_g, ln2_b):
    bsz, seqlen, _ = x.shape
    h = x
    for l in range(DEPTH):
        z = h @ w_in[l]
        q, k, v, u, g = jnp.split(z, SPLITS, axis=-1)
        qh = q.reshape(bsz, seqlen, N_ATTN_GROUPS, HEADS_PER_GROUP, HEAD_DIM)
        kh = k.reshape(bsz, seqlen, N_ATTN_GROUPS, HEADS_PER_GROUP, HEAD_DIM)
        vh = v.reshape(bsz, seqlen, N_ATTN_GROUPS, HEADS_PER_GROUP, HEAD_DIM)

        outs, lses = [], []
        for gi, (window, dilation) in enumerate(DILATION_PATTERNS):
            o, s = dilated_window_attention(
                qh[:, :, gi], kh[:, :, gi], vh[:, :, gi],
                rel_bias[:, gi * HEADS_PER_GROUP:(gi + 1) * HEADS_PER_GROUP],
                window, dilation)
            outs.append(o)
            lses.append(s)
        wts = jax.nn.softmax(jnp.stack(lses), axis=0)
        y_attn = (wts[..., None] * jnp.stack(outs).astype(jnp.float32)).sum(0)
        y_attn = y_attn.astype(h.dtype).reshape(bsz, seqlen, ATTN_OUT_WIDTH)

        y_ssm = jax.nn.gelu(s5_ssm(u, lambda_re[l], lambda_im[l], log_dt[l], ssm_b_re[l],
                                   ssm_b_im[l], ssm_c_re[l], ssm_c_im[l], ssm_d[l]))
        glu_a, glu_b = jnp.split(y_ssm @ w_glu[l], 2, axis=-1)
        y_ssm = glu_a * jax.nn.sigmoid(glu_b)

        gate_ssm, gate_attn = jnp.split(jax.nn.sigmoid(g + b_gate[l]), 2, axis=-1)
        mix = (gate_ssm * (y_ssm @ w_ssm_proj[l]) + gate_attn * (y_attn @ w_attn_proj[l])) @ w_out[l]
        h = layer_norm(ALPHA * h + mix, ln1_g[l], ln1_b[l])

        ff = jnp.square(jax.nn.relu(h @ w_up[l])) @ w_down[l]
        h = layer_norm(ALPHA * h + ff, ln2_g[l], ln2_b[l])
    return h
```

```cpp
#include <hip/hip_runtime.h>
#include <cstdio>
#include <cstdint>
#include <cmath>

namespace nv {
constexpr int D = 1024, NB = 8, L = 4096, M = NB * L, INW = 4864, ZQW = 2816, FF = 4096;
constexpr float ALPHA = 1.189207115002721f;
constexpr float LN_EPS = 1e-5f;

__global__ void __launch_bounds__(256) gemm(const float* __restrict__ A, int lda, const float* __restrict__ W, int ldw, float* __restrict__ C, int ldc, int K) {
    __shared__ float As[16][68];
    __shared__ float Ws[16][64];
    const int tid = threadIdx.x, tx = tid & 15, ty = tid >> 4;
    const int m0 = blockIdx.y * 64, n0 = blockIdx.x * 64;
    float acc[4][4];
#pragma unroll
    for (int i = 0; i < 4; ++i)
#pragma unroll
        for (int j = 0; j < 4; ++j) acc[i][j] = 0.f;
    for (int k0 = 0; k0 < K; k0 += 16) {
        { const int r = tid >> 2, kk = (tid & 3) * 4; const float4 a = *(const float4*)(A + (size_t)(m0 + r) * lda + k0 + kk);
          As[kk][r] = a.x; As[kk + 1][r] = a.y; As[kk + 2][r] = a.z; As[kk + 3][r] = a.w; }
        { const int kr = tid >> 4, nn = (tid & 15) * 4; *(float4*)&Ws[kr][nn] = *(const float4*)(W + (size_t)(k0 + kr) * ldw + n0 + nn); }
        __syncthreads();
#pragma unroll
        for (int k = 0; k < 16; ++k) {
            const float4 a = *(const float4*)&As[k][ty * 4]; const float4 b = *(const float4*)&Ws[k][tx * 4];
            const float av[4] = {a.x, a.y, a.z, a.w}, bv[4] = {b.x, b.y, b.z, b.w};
#pragma unroll
            for (int i = 0; i < 4; ++i)
#pragma unroll
                for (int j = 0; j < 4; ++j) acc[i][j] = fmaf(av[i], bv[j], acc[i][j]);
        }
        __syncthreads();
    }
#pragma unroll
    for (int i = 0; i < 4; ++i) *(float4*)(C + (size_t)(m0 + ty * 4 + i) * ldc + n0 + tx * 4) = make_float4(acc[i][0], acc[i][1], acc[i][2], acc[i][3]);
}

__device__ __forceinline__ float sigmoidf_(float x) { return 1.f / (1.f + expf(-x)); }
__device__ __forceinline__ float gelu_tanh(float x) { return 0.5f * x * (1.f + tanhf(0.7978845608028654f * (x + 0.044715f * x * x * x))); }

__global__ void ew_gate(float* G, const float* __restrict__ bias, size_t n) {
    for (size_t i = (size_t)blockIdx.x * blockDim.x + threadIdx.x; i < n; i += (size_t)gridDim.x * blockDim.x) G[i] = sigmoidf_(G[i] + bias[i & 2047]);
}
__global__ void ew_glu(const float* __restrict__ T, float* GLU, size_t n) {
    for (size_t i = (size_t)blockIdx.x * blockDim.x + threadIdx.x; i < n; i += (size_t)gridDim.x * blockDim.x) { const size_t r = i >> 9, c = i & 511; GLU[i] = T[r * 1024 + c] * sigmoidf_(T[r * 1024 + 512 + c]); }
}
__global__ void ew_merge(const float* __restrict__ G, float* P1, const float* __restrict__ P2, size_t n) {
    for (size_t i = (size_t)blockIdx.x * blockDim.x + threadIdx.x; i < n; i += (size_t)gridDim.x * blockDim.x) { const size_t r = i >> 10, c = i & 1023; P1[i] = G[r * 2048 + c] * P1[i] + G[r * 2048 + 1024 + c] * P2[i]; }
}
__global__ void ew_relu2(float* H, size_t n) {
    for (size_t i = (size_t)blockIdx.x * blockDim.x + threadIdx.x; i < n; i += (size_t)gridDim.x * blockDim.x) { const float v = fmaxf(H[i], 0.f); H[i] = v * v; }
}
__global__ void __launch_bounds__(256) ln_res(const float* __restrict__ base, const float* __restrict__ add, const float* __restrict__ g, const float* __restrict__ b, float* out) {
    __shared__ float red[8];
    const int row = blockIdx.x, tid = threadIdx.x;
    const float4 xb = *(const float4*)(base + (size_t)row * D + tid * 4), xa = *(const float4*)(add + (size_t)row * D + tid * 4);
    float v[4] = {ALPHA * xb.x + xa.x, ALPHA * xb.y + xa.y, ALPHA * xb.z + xa.z, ALPHA * xb.w + xa.w};
    float s = (v[0] + v[1]) + (v[2] + v[3]);
    for (int o = 32; o > 0; o >>= 1) s += __shfl_xor(s, o);
    if ((tid & 63) == 0) red[tid >> 6] = s;
    __syncthreads();
    const float mean = (red[0] + red[1] + red[2] + red[3]) * (1.f / D);
    float q = 0.f;
#pragma unroll
    for (int i = 0; i < 4; ++i) { v[i] -= mean; q += v[i] * v[i]; }
    for (int o = 32; o > 0; o >>= 1) q += __shfl_xor(q, o);
    if ((tid & 63) == 0) red[4 + (tid >> 6)] = q;
    __syncthreads();
    const float rstd = 1.f / sqrtf((red[4] + red[5] + red[6] + red[7]) * (1.f / D) + LN_EPS);
    const float4 gg = *(const float4*)(g + tid * 4), bb = *(const float4*)(b + tid * 4);
    *(float4*)(out + (size_t)row * D + tid * 4) = make_float4(v[0] * rstd * gg.x + bb.x, v[1] * rstd * gg.y + bb.y, v[2] * rstd * gg.z + bb.z, v[3] * rstd * gg.w + bb.w);
}

__device__ __forceinline__ int t5_bucket(int dist) {
    if (dist < 16) return dist;
    int large = 16 + (int)(log((double)dist / 16.0) / log(128.0) * 16.0);
    return large < 31 ? large : 31;
}

__global__ void __launch_bounds__(256) attn(const float* __restrict__ zq, const float* __restrict__ rel_bias, float* __restrict__ yattn) {
    __shared__ float tab[3][132];
    const int tid = threadIdx.x;
    const int idx = blockIdx.x * 256 + tid;
    const int h = idx / M, tok = idx % M;
    for (int e = tid; e < 3 * 129; e += 256) { const int gi = e / 129, j = e % 129, dil = gi == 0 ? 1 : (gi == 1 ? 4 : 16); tab[gi][j] = rel_bias[t5_bucket(j * dil) * 12 + gi * 4 + h]; }
    __syncthreads();
    const int b = tok / L, t = tok % L;
    float O[64];
#pragma unroll
    for (int d = 0; d < 64; ++d) O[d] = 0.f;
    float mrun = -1e30f, lrun = 0.f;
    for (int gi = 0; gi < 3; ++gi) {
        const int dil = gi == 0 ? 1 : (gi == 1 ? 4 : 16);
        const int r = t % dil, m = t / dil;
        float q[64];
        const float* qp = zq + (size_t)tok * ZQW + gi * 256 + h * 64;
#pragma unroll
        for (int d = 0; d < 64; d += 4) { const float4 v = *(const float4*)(qp + d); q[d] = v.x; q[d + 1] = v.y; q[d + 2] = v.z; q[d + 3] = v.w; }
        const int jmax = m < 128 ? m : 128;
        for (int j = 0; j <= jmax; ++j) {
            const int tk = (m - j) * dil + r;
            const float* kp = zq + (size_t)(b * L + tk) * ZQW + 768 + gi * 256 + h * 64;
            float s = 0.f;
#pragma unroll
            for (int d = 0; d < 64; d += 4) { const float4 v = *(const float4*)(kp + d); s = fmaf(q[d], v.x, s); s = fmaf(q[d + 1], v.y, s); s = fmaf(q[d + 2], v.z, s); s = fmaf(q[d + 3], v.w, s); }
            s = s * 0.125f + tab[gi][j];
            const float mn = fmaxf(mrun, s), sc = expf(mrun - mn), p = expf(s - mn);
            lrun = lrun * sc + p; mrun = mn;
            const float* vp = kp + 768;
#pragma unroll
            for (int d = 0; d < 64; d += 4) { const float4 v = *(const float4*)(vp + d); O[d] = O[d] * sc + p * v.x; O[d + 1] = O[d + 1] * sc + p * v.y; O[d + 2] = O[d + 2] * sc + p * v.z; O[d + 3] = O[d + 3] * sc + p * v.w; }
        }
    }
    const float inv = 1.f / lrun;
    float* op = yattn + (size_t)tok * 256 + h * 64;
#pragma unroll
    for (int d = 0; d < 64; d += 4) *(float4*)(op + d) = make_float4(O[d] * inv, O[d + 1] * inv, O[d + 2] * inv, O[d + 3] * inv);
}

__global__ void __launch_bounds__(64) ssm(const float* __restrict__ zq, const float* __restrict__ lam_re, const float* __restrict__ lam_im, const float* __restrict__ log_dt,
                                          const float* __restrict__ b_re, const float* __restrict__ b_im, const float* __restrict__ c_re, const float* __restrict__ c_im,
                                          const float* __restrict__ dsk, float* __restrict__ yssm) {
    __shared__ float cre[16][65], cim[16][65], shr[64], shi[64];
    const int p = threadIdx.x, b = blockIdx.x >> 5, g = blockIdx.x & 31;
    for (int e = p; e < 16 * 64; e += 64) { cre[e >> 6][e & 63] = c_re[g * 1024 + e]; cim[e >> 6][e & 63] = c_im[g * 1024 + e]; }
    const double dt = exp((double)log_dt[g]), lr = lam_re[g * 64 + p], li = lam_im[g * 64 + p];
    const double mag = exp(lr * dt), abr = mag * cos(li * dt), abi = mag * sin(li * dt), den = lr * lr + li * li, nr = abr - 1.0;
    const double kr = (nr * lr + abi * li) / den, ki = (abi * lr - nr * li) / den;
    float Bbr[16], Bbi[16];
#pragma unroll
    for (int h = 0; h < 16; ++h) { const double br = b_re[(g * 64 + p) * 16 + h], bi = b_im[(g * 64 + p) * 16 + h]; Bbr[h] = (float)(kr * br - ki * bi); Bbi[h] = (float)(kr * bi + ki * br); }
    const float ar = (float)abr, ai = (float)abi;
    const float dh = p < 16 ? dsk[g * 16 + p] : 0.f;
    float hr = 0.f, hi = 0.f;
    __syncthreads();
    for (int t = 0; t < L; ++t) {
        const float* up = zq + (size_t)(b * L + t) * ZQW + 2304 + g * 16;
        float u[16];
#pragma unroll
        for (int h = 0; h < 16; h += 4) { const float4 v = *(const float4*)(up + h); u[h] = v.x; u[h + 1] = v.y; u[h + 2] = v.z; u[h + 3] = v.w; }
        float xr = 0.f, xi = 0.f;
#pragma unroll
        for (int h = 0; h < 16; ++h) { xr = fmaf(Bbr[h], u[h], xr); xi = fmaf(Bbi[h], u[h], xi); }
        const float nhr = ar * hr - ai * hi + xr, nhi = ar * hi + ai * hr + xi;
        hr = nhr; hi = nhi;
        shr[p] = hr; shi[p] = hi;
        __syncthreads();
        if (p < 16) {
            float y = 0.f;
            for (int k = 0; k < 64; ++k) y += cre[p][k] * shr[k] - cim[p][k] * shi[k];
            float up_ = 0.f;
#pragma unroll
            for (int h = 0; h < 16; ++h) up_ = (h == p) ? u[h] : up_;
            y += dh * up_;
            yssm[(size_t)(b * L + t) * 512 + g * 16 + p] = gelu_tanh(y);
        }
        __syncthreads();
    }
}
}

extern "C" void kernel_launch(void* const* d_in, const int* in_sizes, int n_in, void* d_out, int out_size, void* d_ws, size_t ws_size, hipStream_t stream) {
    using namespace nv;
    const float* x = (const float*)d_in[0]; const float* w_in = (const float*)d_in[1]; const float* b_gate = (const float*)d_in[2];
    const float* lam_re = (const float*)d_in[3]; const float* lam_im = (const float*)d_in[4]; const float* log_dt = (const float*)d_in[5];
    const float* sb_re = (const float*)d_in[6]; const float* sb_im = (const float*)d_in[7]; const float* sc_re = (const float*)d_in[8]; const float* sc_im = (const float*)d_in[9];
    const float* ssm_d = (const float*)d_in[10]; const float* w_glu = (const float*)d_in[11]; const float* w_sp = (const float*)d_in[12]; const float* rel_bias = (const float*)d_in[13];
    const float* w_ap = (const float*)d_in[14]; const float* w_out = (const float*)d_in[15]; const float* ln1_g = (const float*)d_in[16]; const float* ln1_b = (const float*)d_in[17];
    const float* w_up = (const float*)d_in[18]; const float* w_down = (const float*)d_in[19]; const float* ln2_g = (const float*)d_in[20]; const float* ln2_b = (const float*)d_in[21];
    float* out = (float*)d_out; float* ws = (float*)d_ws;
    float* zq = ws; float* yattn = ws + (size_t)M * ZQW; float* yssm = yattn + (size_t)M * 256;
    gemm<<<dim3(ZQW / 64, M / 64), 256, 0, stream>>>(x, D, w_in, INW, zq, ZQW, D);
    attn<<<M * 4 / 256, 256, 0, stream>>>(zq, rel_bias, yattn);
    ssm<<<256, 64, 0, stream>>>(zq, lam_re, lam_im, log_dt, sb_re, sb_im, sc_re, sc_im, ssm_d, yssm);
    constexpr int R = 8192;
    float* G = ws; float* T1 = G + (size_t)R * 2048; float* GLU = T1 + (size_t)R * 1024; float* P1 = GLU + (size_t)R * 512; float* H1 = P1 + (size_t)R * 1024; float* HID = H1 + (size_t)R * 1024;
    for (int r0 = 0; r0 < M; r0 += R) {
        gemm<<<dim3(2048 / 64, R / 64), 256, 0, stream>>>(x + (size_t)r0 * D, D, w_in + ZQW, INW, G, 2048, D);
        ew_gate<<<2048, 256, 0, stream>>>(G, b_gate, (size_t)R * 2048);
        gemm<<<dim3(1024 / 64, R / 64), 256, 0, stream>>>(yssm + (size_t)r0 * 512, 512, w_glu, 1024, T1, 1024, 512);
        ew_glu<<<2048, 256, 0, stream>>>(T1, GLU, (size_t)R * 512);
        gemm<<<dim3(1024 / 64, R / 64), 256, 0, stream>>>(GLU, 512, w_sp, 1024, P1, 1024, 512);
        gemm<<<dim3(1024 / 64, R / 64), 256, 0, stream>>>(yattn + (size_t)r0 * 256, 256, w_ap, 1024, T1, 1024, 256);
        ew_merge<<<2048, 256, 0, stream>>>(G, P1, T1, (size_t)R * 1024);
        gemm<<<dim3(1024 / 64, R / 64), 256, 0, stream>>>(P1, 1024, w_out, 1024, T1, 1024, 1024);
        ln_res<<<R, 256, 0, stream>>>(x + (size_t)r0 * D, T1, ln1_g, ln1_b, H1);
        gemm<<<dim3(FF / 64, R / 64), 256, 0, stream>>>(H1, 1024, w_up, FF, HID, FF, 1024);
        ew_relu2<<<2048, 256, 0, stream>>>(HID, (size_t)R * FF);
        gemm<<<dim3(1024 / 64, R / 64), 256, 0, stream>>>(HID, FF, w_down, 1024, T1, 1024, FF);
        ln_res<<<R, 256, 0, stream>>>(H1, T1, ln2_g, ln2_b, out + (size_t)r0 * D);
    }
}
```
